# Optimizing an MI355X kernel written in HIP

```python
import jax, jax.numpy as jnp
from jax import lax
import numpy as np

D_MODEL = 2048
BATCH = 2
SEQ = 4096
DEPTH = 1

D_MIX = D_MODEL
GMLP_WIDTH = D_MIX // 2
GMLP_GROUP = 128
GMLP_HEADS = GMLP_WIDTH // GMLP_GROUP
CHUNK = 128
V_HEAD = 128
MLA_WIDTH = D_MIX - GMLP_WIDTH
MLA_HEADS = MLA_WIDTH // V_HEAD
QK_NOPE = 128
QK_ROPE = 64
Q_RANK = D_MODEL // 4
KV_RANK = D_MODEL // 8
IN_COLS = 2 * GMLP_WIDTH + Q_RANK + KV_RANK + QK_ROPE
D_FF = ((8 * D_MODEL // 3 + 255) // 256) * 256
Q_BLOCK = 128
ROPE_THETA = 10000.0
EPS = 1e-6
N_MOD = 9

kernel_name = "hybrid_gmlp_mla_macaron_adaln_encoder"


def _rms(x, g):
    xf = x.astype(jnp.float32)
    y = xf * lax.rsqrt(jnp.mean(xf * xf, axis=-1, keepdims=True) + EPS)
    return (y * g.astype(jnp.float32)).astype(x.dtype)


def _modulate(x, shift, scale):
    return x * (1 + scale[:, None, :]) + shift[:, None, :]


def _swiglu(x, w_gate, w_up, w_down):
    return (jax.nn.silu(x @ w_gate) * (x @ w_up)) @ w_down


def _rotate(x, cos, sin):
    x1, x2 = jnp.split(x, 2, axis=-1)
    return jnp.concatenate([x1 * cos - x2 * sin, x1 * sin + x2 * cos], axis=-1)


def _gmlp_mixer(u, v, v_norm, w_s, b_s):
    B, S, _ = u.shape
    u = jax.nn.gelu(u)
    v = _rms(jax.nn.gelu(v), v_norm)
    v = v.reshape(B, S // CHUNK, CHUNK, GMLP_HEADS, GMLP_GROUP)
    mixed = jnp.einsum('hpq,bnqhc->bnphc', w_s, v) + b_s.T[None, None, :, :, None]
    return u * mixed.reshape(B, S, GMLP_WIDTH)


def _mla_mixer(q_lat, kv_lat, k_pe, cos, sin, q_lat_norm, w_uq, kv_lat_norm, w_ukv,
               q_nope_norm, q_rope_norm, k_nope_norm, k_rope_norm):
    B, S, _ = q_lat.shape
    q = (_rms(q_lat, q_lat_norm) @ w_uq).reshape(B, S, MLA_HEADS, QK_NOPE + QK_ROPE)
    q_nope = _rms(q[..., :QK_NOPE], q_nope_norm)
    q_pe = _rotate(_rms(q[..., QK_NOPE:], q_rope_norm),
                   cos[:, :, None, :], sin[:, :, None, :])
    kv = (_rms(kv_lat, kv_lat_norm) @ w_ukv).reshape(B, S, MLA_HEADS, QK_NOPE + V_HEAD)
    k_nope = _rms(kv[..., :QK_NOPE], k_nope_norm)
    v = kv[..., QK_NOPE:]
    k_pe = _rotate(_rms(k_pe, k_rope_norm), cos, sin)
    scale = (QK_NOPE + QK_ROPE) ** -0.5
    nb = S // Q_BLOCK
    qn_b = q_nope.reshape(B, nb, Q_BLOCK, MLA_HEADS, QK_NOPE).transpose(1, 0, 2, 3, 4)
    qp_b = q_pe.reshape(B, nb, Q_BLOCK, MLA_HEADS, QK_ROPE).transpose(1, 0, 2, 3, 4)

    def block(args):
        qn, qp = args
        s = (jnp.einsum('bqhd,bkhd->bhqk', qn, k_nope)
             + jnp.einsum('bqhd,bkd->bhqk', qp, k_pe))
        p = jax.nn.softmax(s.astype(jnp.float32) * scale, axis=-1).astype(v.dtype)
        return jnp.einsum('bhqk,bkhd->bqhd', p, v)

    o = lax.map(block, (qn_b, qp_b))
    return o.transpose(1, 0, 2, 3, 4).reshape(B, S, MLA_WIDTH)


def setup_inputs(seed: int = 0) -> dict:
    key = jax.random.key(seed)
    ks = iter(jax.random.split(key, 40))

    def nrm(shape, scale):
        return jax.random.normal(next(ks), shape, jnp.float32) * scale

    def gain(shape):
        return 1.0 + 0.02 * jax.random.normal(next(ks), shape, jnp.float32)

    L, D = DEPTH, D_MODEL
    positions = jnp.tile(jnp.arange(SEQ, dtype=jnp.int32)[None, :], (BATCH, 1))
    return {
        "x": nrm((BATCH, SEQ, D), 1.0),
        "c": nrm((BATCH, D), 1.0),
        "positions": positions,
        "w_ada": nrm((L, D, N_MOD * D), 0.5 * D ** -0.5),
        "b_ada": nrm((L, N_MOD * D), 0.01),
        "ffn1_norm": gain((L, D)),
        "ffn1_w_gate": nrm((L, D, D_FF), D ** -0.5),
        "ffn1_w_up": nrm((L, D, D_FF), D ** -0.5),
        "ffn1_w_down": nrm((L, D_FF, D), D_FF ** -0.5),
        "mix_norm": gain((L, D)),
        "w_in": nrm((L, D, IN_COLS), D ** -0.5),
        "gmlp_v_norm": gain((L, GMLP_WIDTH)),
        "gmlp_w_s": nrm((L, GMLP_HEADS, CHUNK, CHUNK), CHUNK ** -0.5),
        "gmlp_b_s": gain((L, GMLP_HEADS, CHUNK)),
        "q_lat_norm": gain((L, Q_RANK)),
        "w_uq": nrm((L, Q_RANK, MLA_HEADS * (QK_NOPE + QK_ROPE)), Q_RANK ** -0.5),
        "kv_lat_norm": gain((L, KV_RANK)),
        "w_ukv": nrm((L, KV_RANK, MLA_HEADS * (QK_NOPE + V_HEAD)), KV_RANK ** -0.5),
        "q_nope_norm": gain((L, QK_NOPE)),
        "q_rope_norm": gain((L, QK_ROPE)),
        "k_nope_norm": gain((L, QK_NOPE)),
        "k_rope_norm": gain((L, QK_ROPE)),
        "out_norm_gmlp": gain((L, GMLP_WIDTH)),
        "out_norm_mla": gain((L, MLA_WIDTH)),
        "w_out": nrm((L, D_MIX, D), D_MIX ** -0.5),
        "ffn2_norm": gain((L, D)),
        "ffn2_w_gate": nrm((L, D, D_FF), D ** -0.5),
        "ffn2_w_up": nrm((L, D, D_FF), D ** -0.5),
        "ffn2_w_down": nrm((L, D_FF, D), D_FF ** -0.5),
        "final_norm": gain((L, D)),
    }


def reference(x, c, positions, w_ada, b_ada, ffn1_norm, ffn1_w_gate, ffn1_w_up, ffn1_w_down,
              mix_norm, w_in, gmlp_v_norm, gmlp_w_s, gmlp_b_s, q_lat_norm, w_uq,
              kv_lat_norm, w_ukv, q_nope_norm, q_rope_norm, k_nope_norm, k_rope_norm,
              out_norm_gmlp, out_norm_mla, w_out, ffn2_norm, ffn2_w_gate, ffn2_w_up,
              ffn2_w_down, final_norm):
    inv_freq = ROPE_THETA ** (-jnp.arange(0, QK_ROPE, 2, dtype=jnp.float32) / QK_ROPE)
    ang = positions.astype(jnp.float32)[..., None] * inv_freq
    cos = jnp.cos(ang).astype(x.dtype)
    sin = jnp.sin(ang).astype(x.dtype)
    c_act = jax.nn.silu(c)
    o1 = 2 * GMLP_WIDTH
    o2 = o1 + Q_RANK
    o3 = o2 + KV_RANK

    h = x
    for l in range(DEPTH):
        mod = c_act @ w_ada[l] + b_ada[l]
        sh1, sc1, g1, sh2, sc2, g2, sh3, sc3, g3 = jnp.split(mod, N_MOD, axis=-1)

        n = _modulate(_rms(h, ffn1_norm[l]), sh1, sc1)
        h = h + 0.5 * g1[:, None, :] * _swiglu(n, ffn1_w_gate[l], ffn1_w_up[l], ffn1_w_down[l])

        n = _modulate(_rms(h, mix_norm[l]), sh2, sc2)
        proj = n @ w_in[l]
        a = _gmlp_mixer(proj[..., :GMLP_WIDTH], proj[..., GMLP_WIDTH:o1],
                        gmlp_v_norm[l], gmlp_w_s[l], gmlp_b_s[l])
        m = _mla_mixer(proj[..., o1:o2], proj[..., o2:o3], proj[..., o3:], cos, sin,
                       q_lat_norm[l], w_uq[l], kv_lat_norm[l], w_ukv[l],
                       q_nope_norm[l], q_rope_norm[l], k_nope_norm[l], k_rope_norm[l])
        merged = jnp.concatenate([_rms(a, out_norm_gmlp[l]), _rms(m, out_norm_mla[l])], axis=-1)
        h = h + g2[:, None, :] * (merged @ w_out[l])

        n = _modulate(_rms(h, ffn2_norm[l]), sh3, sc3)
        h = h + 0.5 * g3[:, None, :] * _swiglu(n, ffn2_w_gate[l], ffn2_w_up[l], ffn2_w_down[l])

        h = _rms(h, final_norm[l])
    return h
```

```cpp
#include <hip/hip_runtime.h>
#include <hip/hip_bf16.h>
#include <cstdio>
#include <cstdint>

constexpr int BATCH = 2, SEQ = 4096, DM = 2048, MROWS = BATCH * SEQ, DFF = 5632, NGU = 2 * DFF;
constexpr int GW = 1024, QRANK = 512, KVRANK = 256, ROPE = 64, INCOLS = 2880, INPAD = 3072;
constexpr int NH = 8, NOPE = 128, VHD = 128, QKD = 192, NQ = NH * QKD  , NKV = NH * (NOPE + VHD)  ;
constexpr int NMOD = 9, MODN = NMOD * DM;
constexpr float EPS = 1e-6f;
namespace pg8 {
#define PG8_LAS __attribute__((address_space(3)))
typedef unsigned short bf16_t;
typedef short bf16x8 __attribute__((ext_vector_type(8)));
typedef float f32x4 __attribute__((ext_vector_type(4)));
typedef unsigned u32x4 __attribute__((ext_vector_type(4)));
constexpr int BM = 256, BK = 64, HALF = 128, HTB = HALF * BK * 2  , STAGE_BYTES = 8 * HTB, NXCD = 8, WGM = 8;

__host__ __device__ __forceinline__ int lds_byte(int r, int c) { const int st = (r >> 4) * 2 + (c >> 5), rr = r & 15, cc = c & 31, ob = rr * 64 + cc * 2; return st * 1024 + (ob ^ (((ob >> 9) & 1) << 5)); }
__host__ __device__ __forceinline__ void stage_rc(int b, int& R, int& C) { const int st = b / 1024, sb = b % 1024, swz = sb ^ (((sb >> 9) & 1) << 5); R = (st >> 1) * 16 + swz / 64; C = (st & 1) * 32 + (swz % 64) / 2; }
__host__ __device__ __forceinline__ int perm32(int rho) { const int n = rho >> 4, i = rho & 15; return 8 * (i >> 2) + 4 * n + (i & 3); }

struct Unit { int pm, pn; };
struct Gemm { const bf16_t* A; const bf16_t* Bt; int M, N, K; };

struct StaticOrder {
    int nM, nN, nwg, G, c;
    __host__ __device__ void init(int M, int N, int G_, int c_) { nM = M / BM; nN = N / BM; nwg = nM * nN; G = G_; c = c_; }
    __host__ __device__ bool next(int i, Unit& u) const {
        const long L = (long)i * G + c; if (L >= nwg) return false;
        int wgid = (int)L; { const int q = nwg / NXCD, r = nwg % NXCD, xcd = wgid % NXCD, off = wgid / NXCD; wgid = (xcd < r ? xcd * (q + 1) : r * (q + 1) + (xcd - r) * q) + off; }
        const int nig = WGM * nN, gid = wgid / nig, fm = gid * WGM, gsz = (nM - fm) < WGM ? (nM - fm) : WGM;
        u.pm = fm + ((wgid % nig) % gsz); u.pn = (wgid % nig) / gsz; return true;
    }
    __device__ __forceinline__ void a_ready(const Unit&) const {}
    __device__ __forceinline__ void done(const Unit&) const {}
};

__device__ __forceinline__ unsigned cvt_pk_bf16(float lo, float hi) { unsigned r; asm volatile("v_cvt_pk_bf16_f32 %0, %1, %2" : "=v"(r) : "v"(lo), "v"(hi)); return r; }
__device__ __forceinline__ float silu_f(float g) { return g * __builtin_amdgcn_rcpf(1.0f + __builtin_amdgcn_exp2f(-1.4426950408889634f * g)); }
__device__ __forceinline__ float gelu_tanh_f(float x) {
    const float t = x * (1.0f + 0.044715f * x * x);
    return x * __builtin_amdgcn_rcpf(1.0f + __builtin_amdgcn_exp2f(-2.3022081986f * t));
}
constexpr int E_MODN = 9 * 2048, E_SEQ = 4096;

struct EpiSwiglu {
    static constexpr bool PERM = true, AFTER_DRAIN = false;
    bf16_t* O; int ldc;
    __device__ __forceinline__ void operator()(const f32x4 (&acc)[2][2][4][2], const Unit& u, int wr, int wc, int fr, int fq) const {
        const int row0 = u.pm * BM + wr * 64 + fr, col0 = u.pn * HALF + wc * 32 + 8 * fq;
#pragma unroll
        for (int ai = 0; ai < 2; ++ai)
#pragma unroll
            for (int m = 0; m < 4; ++m) {
                const f32x4 g0 = acc[ai][0][m][0], g1 = acc[ai][0][m][1], u0 = acc[ai][1][m][0], u1 = acc[ai][1][m][1];
                u32x4 w;
                w.x = cvt_pk_bf16(silu_f(g0[0]) * u0[0], silu_f(g0[1]) * u0[1]); w.y = cvt_pk_bf16(silu_f(g0[2]) * u0[2], silu_f(g0[3]) * u0[3]);
                w.z = cvt_pk_bf16(silu_f(g1[0]) * u1[0], silu_f(g1[1]) * u1[1]); w.w = cvt_pk_bf16(silu_f(g1[2]) * u1[2], silu_f(g1[3]) * u1[3]);
                *(u32x4*)(O + (size_t)(row0 + ai * HALF + m * 16) * ldc + col0) = w;
            }
    }
};

struct EpiResid {
    static constexpr bool PERM = false, AFTER_DRAIN = false;
    const float* base; float* out; int ldc; const float* gate  ; float gs;
    __device__ __forceinline__ void operator()(const f32x4 (&acc)[2][2][4][2], const Unit& u, int wr, int wc, int fr, int fq) const {
        const int col0 = u.pn * BM + wc * 32 + 4 * fq; const int b = (u.pm * BM) / E_SEQ;
        const float* gp = gate + (size_t)b * E_MODN + col0;
        f32x4 gv[2][2];
#pragma unroll
        for (int bj = 0; bj < 2; ++bj)
#pragma unroll
            for (int n = 0; n < 2; ++n) gv[bj][n] = *(const f32x4*)(gp + bj * HALF + n * 16) * gs;
#pragma unroll
        for (int ai = 0; ai < 2; ++ai)
#pragma unroll
            for (int m = 0; m < 4; ++m) { const size_t off = (size_t)(u.pm * BM + ai * HALF + wr * 64 + m * 16 + fr) * ldc + col0;
#pragma unroll
                for (int bj = 0; bj < 2; ++bj)
#pragma unroll
                    for (int n = 0; n < 2; ++n) { const f32x4 bs = *(const f32x4*)(base + off + bj * HALF + n * 16);
                        *(f32x4*)(out + off + bj * HALF + n * 16) = bs + gv[bj][n] * acc[ai][bj][m][n]; }
                if (m & 1) asm volatile("" ::: "memory"); }
    }
};

struct EpiWin {
    static constexpr bool PERM = true, AFTER_DRAIN = false;
    bf16_t *U, *VG, *QL, *KVL; float *KPE, *part_v  , *part_q  , *part_kv  ;
    __device__ __forceinline__ void operator()(const f32x4 (&acc)[2][2][4][2], const Unit& u, int wr, int wc, int fr, int fq) const {
        const int row0 = u.pm * BM + wr * 64 + fr; const int pn = u.pn;
        if (pn == 11) {
            if (wc < 2) {
#pragma unroll
                for (int ai = 0; ai < 2; ++ai)
#pragma unroll
                    for (int m = 0; m < 4; ++m) { float* p = KPE + (size_t)(row0 + ai * HALF + m * 16) * 64 + wc * 32 + 8 * fq;
                        *(f32x4*)p = acc[ai][0][m][0]; *(f32x4*)(p + 4) = acc[ai][0][m][1]; }
            }
            return;
        }
        bf16_t* base; int ldc, colt; float* part; int pstride, pidx; bool act;
        if (pn < 4)       { base = U;   ldc = 1024; colt = pn * BM;        part = nullptr; pstride = 0;  pidx = 0;                 act = true; }
        else if (pn < 8)  { base = VG;  ldc = 1024; colt = (pn - 4) * BM;  part = part_v;  pstride = 16; pidx = (pn - 4) * 4 + wc; act = true; }
        else if (pn < 10) { base = QL;  ldc = 512;  colt = (pn - 8) * BM;  part = part_q;  pstride = 8;  pidx = (pn - 8) * 4 + wc; act = false; }
        else              { base = KVL; ldc = 256;  colt = 0;              part = part_kv; pstride = 4;  pidx = wc;                act = false; }
        const int col0 = colt + wc * 32 + 8 * fq;
#pragma unroll
        for (int ai = 0; ai < 2; ++ai)
#pragma unroll
            for (int m = 0; m < 4; ++m) {
                float ss = 0.f; bf16_t* rowp = base + (size_t)(row0 + ai * HALF + m * 16) * ldc + col0;
#pragma unroll
                for (int bj = 0; bj < 2; ++bj) { f32x4 v0 = acc[ai][bj][m][0], v1 = acc[ai][bj][m][1];
                    if (act) {
#pragma unroll
                        for (int e = 0; e < 4; ++e) { v0[e] = gelu_tanh_f(v0[e]); v1[e] = gelu_tanh_f(v1[e]); } }
                    ss += (v0[0] * v0[0] + v0[1] * v0[1]) + (v0[2] * v0[2] + v0[3] * v0[3]) + (v1[0] * v1[0] + v1[1] * v1[1]) + (v1[2] * v1[2] + v1[3] * v1[3]);
                    u32x4 w; w.x = cvt_pk_bf16(v0[0], v0[1]); w.y = cvt_pk_bf16(v0[2], v0[3]); w.z = cvt_pk_bf16(v1[0], v1[1]); w.w = cvt_pk_bf16(v1[2], v1[3]);
                    *(u32x4*)(rowp + bj * HALF) = w; }
                if (part) { ss += __shfl_xor(ss, 16); ss += __shfl_xor(ss, 32);
                    if (fq == 0) part[(size_t)(row0 + ai * HALF + m * 16) * pstride + pidx] = ss; }
            }
    }
};

struct EpiF32Rs {
    static constexpr bool PERM = false, AFTER_DRAIN = false;
    float* O; int ldc; const float* part; int np; float invw, eps;
    __device__ __forceinline__ void operator()(const f32x4 (&acc)[2][2][4][2], const Unit& u, int wr, int wc, int fr, int fq) const {
        const int col0 = u.pn * BM + wc * 32 + 4 * fq;
#pragma unroll
        for (int ai = 0; ai < 2; ++ai)
#pragma unroll
            for (int m = 0; m < 4; ++m) { const int row = u.pm * BM + ai * HALF + wr * 64 + m * 16 + fr;
                const f32x4 p0 = *(const f32x4*)(part + (size_t)row * np); float s = (p0[0] + p0[1]) + (p0[2] + p0[3]);
                if (np == 8) { const f32x4 p1 = *(const f32x4*)(part + (size_t)row * np + 4); s += (p1[0] + p1[1]) + (p1[2] + p1[3]); }
                const float rs = 1.0f / sqrtf(s * invw + eps);
                float* op = O + (size_t)row * ldc + col0;
#pragma unroll
                for (int bj = 0; bj < 2; ++bj)
#pragma unroll
                    for (int n = 0; n < 2; ++n) *(f32x4*)(op + bj * HALF + n * 16) = acc[ai][bj][m][n] * rs; }
    }
};

template <class Epi, class Sched, bool ALIGN_EPI = false, bool SP2 = false>
__device__ __forceinline__ void gemm_phase(PG8_LAS unsigned char* lds, const Gemm g, const Sched& S, const Epi& E) {
    const int tid = threadIdx.x, wid = __builtin_amdgcn_readfirstlane(tid >> 6), lane = tid & 63, wr = wid >> 2, wc = wid & 3, fr = lane & 15, fq = lane >> 4;
    const int K = g.K, nt = K / BK;
    unsigned voffA[2], voffB[2];
#pragma unroll
    for (int i = 0; i < 2; ++i) { int R, C; stage_rc(tid * 16 + i * 8192, R, C); const int Rb = Epi::PERM ? ((R & ~31) + perm32(R & 31)) : R;
        voffA[i] = (unsigned)(R * K + C) * 2u; voffB[i] = (unsigned)(Rb * K + C) * 2u; }
    const size_t kstep = (size_t)(BK * 2);
    const size_t hstep = (size_t)HALF * K * 2;
    const size_t tstep = 2 * hstep;
    const unsigned ldsw = (unsigned)wid * 1024u;
    const int aoff = lds_byte(wr * 64 + fr, fq * 8), boff = lds_byte(wc * 32 + fr, fq * 8);
#define PG8_SA(b, h) (((b) * 2 + (h)) * HTB)
#define PG8_SB(b, h) ((4 + (b) * 2 + (h)) * HTB)
#define PG8_STAGE(bufoff, gbase, voff) do { _Pragma("unroll") for (int _i = 0; _i < 2; ++_i) \
        __builtin_amdgcn_global_load_lds((const unsigned*)((const char*)(gbase) + (voff)[_i]), (PG8_LAS unsigned*)(lds + (bufoff) + ldsw + _i * 8192), 16, 0, 0); } while (0)
#define PG8_LDA(dst, b, h) do { _Pragma("unroll") for (int m = 0; m < 4; ++m) _Pragma("unroll") for (int k = 0; k < 2; ++k) dst[m][k] = *(const PG8_LAS bf16x8*)(lds + PG8_SA(b, h) + aoff + m * 2048 + k * 1024); } while (0)
#define PG8_LDB(dst, b, h) do { _Pragma("unroll") for (int n = 0; n < 2; ++n) _Pragma("unroll") for (int k = 0; k < 2; ++k) dst[n][k] = *(const PG8_LAS bf16x8*)(lds + PG8_SB(b, h) + boff + n * 2048 + k * 1024); } while (0)
#define PG8_MMA(ai, bj, At, Bt) do { __builtin_amdgcn_s_setprio(1); _Pragma("unroll") for (int m = 0; m < 4; ++m) _Pragma("unroll") for (int n = 0; n < 2; ++n) _Pragma("unroll") for (int k = 0; k < 2; ++k) \
        acc[ai][bj][m][n] = __builtin_amdgcn_mfma_f32_16x16x32_bf16(Bt[n][k], At[m][k], acc[ai][bj][m][n], 0, 0, 0); __builtin_amdgcn_s_setprio(0); } while (0)
#define PG8_WAIT_V(n) asm volatile("s_waitcnt vmcnt(" #n ")" ::: "memory")
#define PG8_WAIT_L(n) asm volatile("s_waitcnt lgkmcnt(" #n ")" ::: "memory")
#define PG8_BAR __builtin_amdgcn_s_barrier()
#define PG8_SCHED __builtin_amdgcn_sched_barrier(0)
    Unit cur, nxt; int ui = 0;
    if (!S.next(0, cur)) return;
    f32x4 acc[2][2][4][2];
#pragma unroll
    for (int a = 0; a < 2; ++a)
#pragma unroll
        for (int b = 0; b < 2; ++b)
#pragma unroll
            for (int m = 0; m < 4; ++m)
#pragma unroll
                for (int n = 0; n < 2; ++n) acc[a][b][m][n] = (f32x4){0.f, 0.f, 0.f, 0.f};
    bf16x8 At[4][2], B0[2][2], B1[2][2];
    const char* cA = (const char*)g.A + (size_t)cur.pm * tstep; const char* cB = (const char*)g.Bt + (size_t)cur.pn * tstep;
    S.a_ready(cur);
    if constexpr (SP2) {
        PG8_STAGE(PG8_SB(0, 0), cB, voffB); PG8_STAGE(PG8_SB(0, 1), cB + hstep, voffB); PG8_STAGE(PG8_SA(0, 0), cA, voffA); PG8_STAGE(PG8_SA(0, 1), cA + hstep, voffA);
        if (wr == 1) PG8_BAR;
        PG8_WAIT_V(2); PG8_BAR;
        PG8_STAGE(PG8_SB(1, 0), cB + kstep, voffB); PG8_STAGE(PG8_SA(1, 0), cA + kstep, voffA); PG8_STAGE(PG8_SB(1, 1), cB + hstep + kstep, voffB);
        PG8_WAIT_V(6); PG8_BAR;
    } else {
        PG8_STAGE(PG8_SB(0, 0), cB, voffB); PG8_STAGE(PG8_SA(0, 0), cA, voffA); PG8_STAGE(PG8_SB(0, 1), cB + hstep, voffB); PG8_STAGE(PG8_SA(0, 1), cA + hstep, voffA);
        if (wr == 1) PG8_BAR;
        PG8_WAIT_V(4); PG8_BAR;
        PG8_STAGE(PG8_SB(1, 0), cB + kstep, voffB); PG8_STAGE(PG8_SA(1, 0), cA + kstep, voffA); PG8_STAGE(PG8_SB(1, 1), cB + hstep + kstep, voffB);
        PG8_WAIT_V(6); PG8_BAR;
    }
    for (;;) {
        const bool has_next = S.next(ui + 1, nxt);
        const char* nA = has_next ? (const char*)g.A + (size_t)nxt.pm * tstep : cA; const char* nB = has_next ? (const char*)g.Bt + (size_t)nxt.pn * tstep : cB;
        for (int t = 0; t < nt; t += 2) {
            const bool last = (t == nt - 2);
            const char* a1 = cA + (size_t)(t + 1) * kstep;
            const char* a2 = last ? nA : cA + (size_t)(t + 2) * kstep; const char* b2 = last ? nB : cB + (size_t)(t + 2) * kstep;
            const char* a3 = a2 + kstep; const char* b3 = b2 + kstep;
            if (last && has_next) S.a_ready(nxt);
            if constexpr (SP2) {
            PG8_LDB(B0, 0, 0); PG8_LDB(B1, 0, 1); PG8_SCHED; PG8_LDA(At, 0, 0); PG8_STAGE(PG8_SA(1, 1), a1 + hstep, voffA);
            PG8_WAIT_V(8); PG8_WAIT_L(0); PG8_BAR; PG8_MMA(0, 0, At, B0); PG8_MMA(0, 1, At, B1); PG8_BAR; PG8_SCHED;
            PG8_LDA(At, 0, 1); PG8_STAGE(PG8_SB(0, 0), b2, voffB); PG8_STAGE(PG8_SB(0, 1), b2 + hstep, voffB); PG8_STAGE(PG8_SA(0, 0), a2, voffA);
            PG8_WAIT_V(8); PG8_WAIT_L(0); PG8_BAR; PG8_MMA(1, 0, At, B0); PG8_MMA(1, 1, At, B1); PG8_BAR; PG8_SCHED;
            PG8_LDB(B0, 1, 0); PG8_LDB(B1, 1, 1); PG8_SCHED; PG8_LDA(At, 1, 0); PG8_STAGE(PG8_SA(0, 1), a2 + hstep, voffA);
            PG8_WAIT_V(8); PG8_WAIT_L(0); PG8_BAR; PG8_MMA(0, 0, At, B0); PG8_MMA(0, 1, At, B1); PG8_BAR; PG8_SCHED;
            PG8_LDA(At, 1, 1); PG8_STAGE(PG8_SB(1, 0), b3, voffB); PG8_STAGE(PG8_SB(1, 1), b3 + hstep, voffB); PG8_STAGE(PG8_SA(1, 0), a3, voffA);
            PG8_WAIT_V(8); PG8_WAIT_L(0); PG8_BAR; PG8_MMA(1, 0, At, B0); PG8_MMA(1, 1, At, B1); PG8_BAR; PG8_SCHED;
            } else {
            PG8_LDB(B0, 0, 0); PG8_SCHED; PG8_LDA(At, 0, 0); PG8_STAGE(PG8_SA(1, 1), a1 + hstep, voffA);
            PG8_WAIT_L(8); PG8_BAR; PG8_WAIT_L(0); PG8_MMA(0, 0, At, B0); PG8_BAR; PG8_SCHED;
            PG8_LDB(B1, 0, 1); PG8_STAGE(PG8_SB(0, 0), b2, voffB);
            PG8_BAR; PG8_WAIT_L(0); PG8_MMA(0, 1, At, B1); PG8_BAR;
            PG8_LDA(At, 0, 1); PG8_STAGE(PG8_SA(0, 0), a2, voffA);
            PG8_BAR; PG8_WAIT_L(0); PG8_MMA(1, 0, At, B0); PG8_BAR; PG8_SCHED;
            PG8_STAGE(PG8_SB(0, 1), b2 + hstep, voffB);
            PG8_WAIT_V(6); PG8_BAR; PG8_MMA(1, 1, At, B1); PG8_BAR;
            PG8_LDB(B0, 1, 0); PG8_SCHED; PG8_LDA(At, 1, 0); PG8_STAGE(PG8_SA(0, 1), a2 + hstep, voffA);
            PG8_WAIT_L(8); PG8_BAR; PG8_WAIT_L(0); PG8_MMA(0, 0, At, B0); PG8_BAR; PG8_SCHED;
            PG8_LDB(B1, 1, 1); PG8_STAGE(PG8_SB(1, 0), b3, voffB);
            PG8_BAR; PG8_WAIT_L(0); PG8_MMA(0, 1, At, B1); PG8_BAR;
            PG8_LDA(At, 1, 1); PG8_STAGE(PG8_SA(1, 0), a3, voffA);
            PG8_BAR; PG8_WAIT_L(0); PG8_MMA(1, 0, At, B0); PG8_BAR; PG8_SCHED;
            PG8_STAGE(PG8_SB(1, 1), b3 + hstep, voffB);
            PG8_WAIT_V(6); PG8_BAR; PG8_MMA(1, 1, At, B1); PG8_BAR;
            }
        }
        if constexpr (ALIGN_EPI) { if (wr == 0) PG8_BAR; }
        if constexpr (!Epi::AFTER_DRAIN) { E(acc, cur, wr, wc, fr, fq); S.done(cur); }
        if (!has_next) break;
#pragma unroll
        for (int a = 0; a < 2; ++a)
#pragma unroll
            for (int b = 0; b < 2; ++b)
#pragma unroll
                for (int m = 0; m < 4; ++m)
#pragma unroll
                    for (int n = 0; n < 2; ++n) acc[a][b][m][n] = (f32x4){0.f, 0.f, 0.f, 0.f};
        cur = nxt; cA = nA; cB = nB; ++ui;
        if constexpr (ALIGN_EPI) { if (wr == 1) PG8_BAR; }
    }
    PG8_WAIT_V(0);
    if constexpr (!ALIGN_EPI) { if (wr == 0) PG8_BAR; }
    PG8_BAR;
    if constexpr (Epi::AFTER_DRAIN) { E.fused(acc, cur, wr, wc, fr, fq, lds, wid, lane); S.done(cur); }
#undef PG8_SA
#undef PG8_SB
#undef PG8_STAGE
#undef PG8_LDA
#undef PG8_LDB
#undef PG8_MMA
#undef PG8_WAIT_V
#undef PG8_WAIT_L
#undef PG8_BAR
#undef PG8_SCHED
}
}
namespace att {
using bf16 = __hip_bfloat16;
using bf16x8 = __attribute__((ext_vector_type(8))) short;
using s16x4  = __attribute__((ext_vector_type(4))) short;
using f32x16 = __attribute__((ext_vector_type(16))) float;
using u32x4  = __attribute__((ext_vector_type(4))) unsigned;
constexpr int DV = 128, DQ = 192, NW = 8, QBLK = 32, KVBLK = 64;
constexpr float SCALE = 0.07216878364870322f;
#ifndef ATTN_THR
#define ATTN_THR 8.f
#endif
constexpr float THR = ATTN_THR;
#ifndef ATTN_SDEPTH
#define ATTN_SDEPTH 1
#endif
constexpr int SDEPTH = ATTN_SDEPTH;
constexpr int SHM_V = KVBLK * DV * 2  , SHM_K = KVBLK * DQ * 2  , SHM_WS = 2 * SHM_V + 2 * SHM_K, SHM_QPE = SHM_WS + NW * 64 * 4, SHM_ATTN = SHM_QPE + NW * 4096;
#define KSWZ(row, colB) ((row) * 384 + ((colB) ^ (((row) & 7) << 4)))
#define SBAR() __builtin_amdgcn_sched_barrier(0)
__device__ __forceinline__ int crow(int r, int hi) { return (r & 3) + 8 * (r >> 2) + 4 * hi; }
__device__ __forceinline__ unsigned cvtpk(float lo, float hi) { unsigned r; asm volatile("v_cvt_pk_bf16_f32 %0, %1, %2" : "=v"(r) : "v"(lo), "v"(hi)); return r; }

__device__ __forceinline__ void partialSM(f32x16& p0, f32x16& p1, float& m_reg, float& mn, float& alpha) {
  constexpr float C = SCALE * 1.4426950408889634f;
  float pmax = p0[0]; for (int r = 1; r < 16; ++r) pmax = fmaxf(pmax, p0[r]); for (int r = 0; r < 16; ++r) pmax = fmaxf(pmax, p1[r]);
  { auto rr = __builtin_amdgcn_permlane32_swap(__float_as_uint(pmax), __float_as_uint(pmax), false, false);
    pmax = fmaxf(__uint_as_float(rr[0]), __uint_as_float(rr[1])); }
  if (__builtin_expect(__all(pmax - m_reg <= THR / SCALE), 1)) { mn = m_reg; alpha = 1.f; }
  else { mn = fmaxf(m_reg, pmax); alpha = __builtin_amdgcn_exp2f((m_reg - mn) * C); m_reg = mn; }
  float mnC = -mn * C;
  for (int r = 0; r < 16; ++r) p0[r] = fmaf(p0[r], C, mnC); for (int r = 0; r < 16; ++r) p1[r] = fmaf(p1[r], C, mnC);
  for (int r = 0; r < 16; ++r) p0[r] = __builtin_amdgcn_exp2f(p0[r]);
}
__device__ __forceinline__ void finishSM(f32x16& p0, f32x16& p1, float alpha, float& l_reg, bf16x8& pa0, bf16x8& pa1, bf16x8& pa2, bf16x8& pa3) {
  for (int r = 0; r < 16; ++r) p1[r] = __builtin_amdgcn_exp2f(p1[r]);
  float ps = 0; for (int r = 0; r < 16; ++r) ps += p0[r]; for (int r = 0; r < 16; ++r) ps += p1[r];
  { auto rr = __builtin_amdgcn_permlane32_swap(__float_as_uint(ps), __float_as_uint(ps), false, false);
    ps = __uint_as_float(rr[0]) + __uint_as_float(rr[1]); }
  l_reg = l_reg * alpha + ps;
#define PK4(P, BASE, OUT) do { unsigned a0 = cvtpk(P[BASE + 0], P[BASE + 1]), a1 = cvtpk(P[BASE + 2], P[BASE + 3]);   \
    unsigned b0 = cvtpk(P[BASE + 4], P[BASE + 5]), b1 = cvtpk(P[BASE + 6], P[BASE + 7]);                              \
    auto r0 = __builtin_amdgcn_permlane32_swap(a0, b0, false, false); auto r1 = __builtin_amdgcn_permlane32_swap(a1, b1, false, false); \
    u32x4 w = {r0[0], r1[0], r0[1], r1[1]}; OUT = *reinterpret_cast<bf16x8*>(&w); } while (0)
  PK4(p0, 0, pa0); PK4(p0, 8, pa1); PK4(p1, 0, pa2); PK4(p1, 8, pa3);
#undef PK4
}
__device__ __forceinline__ void qkt(f32x16& p0, f32x16& p1, const char* Ks, const bf16x8* qr, const char* qpe, int r32, int hi) {
  p0 = f32x16{}; p1 = f32x16{};
#pragma unroll
  for (int d0 = 0; d0 < 12; ++d0) { int cb = (d0 * 16 + hi * 8) * 2;
    bf16x8 b0 = *reinterpret_cast<const bf16x8*>(Ks + KSWZ(r32, cb));
    bf16x8 b1 = *reinterpret_cast<const bf16x8*>(Ks + KSWZ(32 + r32, cb));
    const bf16x8 q = d0 < 8 ? qr[d0 < 8 ? d0 : 0] : *reinterpret_cast<const bf16x8*>(qpe + (d0 - 8) * 1024);
    p0 = __builtin_amdgcn_mfma_f32_32x32x16_bf16(b0, q, p0, 0, 0, 0);
    p1 = __builtin_amdgcn_mfma_f32_32x32x16_bf16(b1, q, p1, 0, 0, 0); }
}
__device__ __forceinline__ int v_st(int k, int c) { const int kk = (k & ~0xC) | ((k & 4) << 1) | ((k & 8) >> 1); return ((kk >> 3) * 4 + (c >> 5)) * 512 + ((kk & 7) * 32 + (c & 31)) * 2; }
__device__ __forceinline__ int v_rd_base(int lane) { return ((lane & 3) << 3) | (((lane >> 2) & 3) << 6) | (((lane >> 4) & 1) << 5) | (((lane >> 5) & 1) << 8); }
constexpr int v_rd_off(int d0, int ks, int half) { return d0 * 512 + ks * 4096 + half * 2048; }
template <int OFF> __device__ __forceinline__ s16x4 tr_read(int vb) {
  s16x4 r; asm volatile("ds_read_b64_tr_b16 %0, %1 offset:%2" : "=&v"(r) : "v"(vb), "i"(OFF) : "memory"); return r;
}
template <int D0> __device__ __forceinline__ void pv_one(f32x16& od, int vb, bf16x8 pa0, bf16x8 pa1, bf16x8 pa2, bf16x8 pa3) {
  const s16x4 l0 = tr_read<v_rd_off(D0, 0, 0)>(vb), h0 = tr_read<v_rd_off(D0, 0, 1)>(vb), l1 = tr_read<v_rd_off(D0, 1, 0)>(vb), h1 = tr_read<v_rd_off(D0, 1, 1)>(vb);
  const s16x4 l2 = tr_read<v_rd_off(D0, 2, 0)>(vb), h2 = tr_read<v_rd_off(D0, 2, 1)>(vb), l3 = tr_read<v_rd_off(D0, 3, 0)>(vb), h3 = tr_read<v_rd_off(D0, 3, 1)>(vb);
  asm volatile("s_waitcnt lgkmcnt(0)" ::: "memory"); SBAR();
#define PK(L, H) (bf16x8){L[0], L[1], L[2], L[3], H[0], H[1], H[2], H[3]}
  od = __builtin_amdgcn_mfma_f32_32x32x16_bf16(pa0, PK(l0, h0), od, 0, 0, 0);
  od = __builtin_amdgcn_mfma_f32_32x32x16_bf16(pa1, PK(l1, h1), od, 0, 0, 0);
  od = __builtin_amdgcn_mfma_f32_32x32x16_bf16(pa2, PK(l2, h2), od, 0, 0, 0);
  od = __builtin_amdgcn_mfma_f32_32x32x16_bf16(pa3, PK(l3, h3), od, 0, 0, 0);
#undef PK
}
__device__ __forceinline__ void pv_d0(f32x16* o, int vb, bf16x8 pa0, bf16x8 pa1, bf16x8 pa2, bf16x8 pa3) {
  pv_one<0>(o[0], vb, pa0, pa1, pa2, pa3); pv_one<1>(o[1], vb, pa0, pa1, pa2, pa3); pv_one<2>(o[2], vb, pa0, pa1, pa2, pa3); pv_one<3>(o[3], vb, pa0, pa1, pa2, pa3);
}

__device__ __forceinline__ void attn_dense_body(const bf16* __restrict__ Qb, const bf16* __restrict__ Kh, const bf16* __restrict__ Vh,
                                                unsigned short* __restrict__ Ob, int ldo, int seq, char* lds) {
  const int tid = threadIdx.x, wid = tid >> 6, lane = tid & 63, r32 = lane & 31, hi = lane >> 5;
  char* V_lds = lds; char* K_lds = lds + 2 * SHM_V;
  float* ws = (float*)(lds + SHM_WS) + wid * 64; float* li_l = ws; float* al_l = ws + 32;
  float m_reg = -1e30f, l_reg = 0; f32x16 o[4] = {}; bf16x8 qr[8];
  char* qpe = lds + SHM_QPE + wid * 4096 + lane * 16;
  const bf16* Qw = Qb + (long)(wid * QBLK + r32) * DQ + hi * 8;
#pragma unroll
  for (int d0 = 0; d0 < 8; ++d0) qr[d0] = *reinterpret_cast<const bf16x8*>(Qw + d0 * 16);
#pragma unroll
  for (int d0 = 8; d0 < 12; ++d0) *reinterpret_cast<bf16x8*>(qpe + (d0 - 8) * 1024) = *reinterpret_cast<const bf16x8*>(Qw + d0 * 16);
  int kst[3];
#pragma unroll
  for (int i = 0; i < 3; ++i) { const int p = tid + 512 * i, row = p / 24, ch = p - row * 24; kst[i] = KSWZ(row, ch * 16); }
  const int sr = tid >> 4, sc = (tid & 15) * 8, vst0 = v_st(sr, sc), vst1 = v_st(32 + sr, sc);
  const int vb0 = (int)(uintptr_t)V_lds + v_rd_base(lane);
  struct { bf16x8 vs0, vs1, ks0, ks1, ks2; } sr_[SDEPTH];
#define SLOAD(i, k0) do { const char* vt_ = (const char*)(Vh + (long)(k0) * DV); const char* kt_ = (const char*)(Kh + (long)(k0) * DQ); \
    sr_[i].vs0 = *(const bf16x8*)(vt_ + tid * 16); sr_[i].vs1 = *(const bf16x8*)(vt_ + 8192 + tid * 16); \
    sr_[i].ks0 = *(const bf16x8*)(kt_ + tid * 16); sr_[i].ks1 = *(const bf16x8*)(kt_ + 8192 + tid * 16); sr_[i].ks2 = *(const bf16x8*)(kt_ + 16384 + tid * 16); } while (0)
#define SWRITE(b, i) do { *(bf16x8*)(V_lds + (b) * SHM_V + vst0) = sr_[i].vs0; *(bf16x8*)(V_lds + (b) * SHM_V + vst1) = sr_[i].vs1; \
    *(bf16x8*)(K_lds + (b) * SHM_K + kst[0]) = sr_[i].ks0; *(bf16x8*)(K_lds + (b) * SHM_K + kst[1]) = sr_[i].ks1; *(bf16x8*)(K_lds + (b) * SHM_K + kst[2]) = sr_[i].ks2; } while (0)
#define SWAIT() do { if constexpr (SDEPTH == 2) asm volatile("s_waitcnt vmcnt(5)" ::: "memory"); else asm volatile("s_waitcnt vmcnt(0)" ::: "memory"); } while (0)
#define RESC(a) do { if (__any((a) < 1.f)) { if (hi == 0) al_l[r32] = (a); asm volatile("s_waitcnt lgkmcnt(0)" ::: "memory"); \
    for (int d = 0; d < 4; ++d) for (int r = 0; r < 16; ++r) o[d][r] *= al_l[crow(r, hi)]; } } while (0)
  f32x16 pA0, pA1, pB0, pB1; float mnA, mnB, alA, alB; bf16x8 pa0, pa1, pa2, pa3; const int NT = seq / KVBLK;
  constexpr int SE = 0, SO = SDEPTH - 1;
  SLOAD(SE, 0); asm volatile("s_waitcnt vmcnt(0)" ::: "memory"); SWRITE(0, SE); __syncthreads();
  qkt(pA0, pA1, K_lds, qr, qpe, r32, hi); partialSM(pA0, pA1, m_reg, mnA, alA);
  SLOAD(SO, KVBLK); if constexpr (SDEPTH == 2) { if (2 < NT) SLOAD(SE, 2 * KVBLK); }
  SWAIT(); SWRITE(1, SO); __syncthreads();
  for (int j = 1; j + 1 < NT; j += 2) {
    SBAR(); qkt(pB0, pB1, K_lds + SHM_K, qr, qpe, r32, hi);
    finishSM(pA0, pA1, alA, l_reg, pa0, pa1, pa2, pa3); SBAR();
    SLOAD(SO, (j + SDEPTH) * KVBLK); SBAR();
    pv_d0(o, vb0, pa0, pa1, pa2, pa3); partialSM(pB0, pB1, m_reg, mnB, alB);
    __syncthreads(); SWAIT(); SWRITE(0, SE);
    RESC(alB); __syncthreads();
    SBAR(); qkt(pA0, pA1, K_lds, qr, qpe, r32, hi);
    finishSM(pB0, pB1, alB, l_reg, pa0, pa1, pa2, pa3); SBAR();
    if (SDEPTH == 1 || j + 3 < NT) SLOAD(SE, (j + 1 + SDEPTH) * KVBLK); SBAR();
    pv_d0(o, vb0 + SHM_V, pa0, pa1, pa2, pa3); partialSM(pA0, pA1, m_reg, mnA, alA);
    __syncthreads(); SWAIT(); SWRITE(1, SO);
    RESC(alA); __syncthreads();
  }
  SBAR(); qkt(pB0, pB1, K_lds + SHM_K, qr, qpe, r32, hi);
  finishSM(pA0, pA1, alA, l_reg, pa0, pa1, pa2, pa3); SBAR();
  pv_d0(o, vb0, pa0, pa1, pa2, pa3); partialSM(pB0, pB1, m_reg, mnB, alB);
  __syncthreads(); RESC(alB);
  finishSM(pB0, pB1, alB, l_reg, pa0, pa1, pa2, pa3); SBAR();
  pv_d0(o, vb0 + SHM_V, pa0, pa1, pa2, pa3);
  if (hi == 0) li_l[r32] = l_reg; asm volatile("s_waitcnt lgkmcnt(0)" ::: "memory");
  float rli[16];
#pragma unroll
  for (int r = 0; r < 16; ++r) rli[r] = __builtin_amdgcn_rcpf(li_l[crow(r, hi)]);
  unsigned short* Ow = Ob + (long)(wid * QBLK) * ldo;
#pragma unroll
  for (int r = 0; r < 16; ++r) { int orow = crow(r, hi);
#pragma unroll
    for (int d0 = 0; d0 < 4; d0 += 2) { const unsigned w = cvtpk(o[d0][r] * rli[r], o[d0 + 1][r] * rli[r]);
      Ow[(long)orow * ldo + d0 * 32 + r32] = (unsigned short)(w & 0xffffu); Ow[(long)orow * ldo + (d0 + 1) * 32 + r32] = (unsigned short)(w >> 16); } }
#undef SLOAD
#undef SWRITE
#undef SWAIT
#undef RESC
}
#undef KSWZ
#undef SBAR
}
constexpr int NWAVES = 8;
#ifndef MK_N_LAUNCHES
#define MK_N_LAUNCHES 15
#endif
constexpr int N_PHASES = 15;
constexpr int N_LAUNCHES = MK_N_LAUNCHES;

constexpr size_t MiB = 1u << 20;
constexpr size_t WS_CTL = 0, CTL_ZERO_BYTES = 1 * MiB;
constexpr size_t WS_MOD = 1 * MiB;
constexpr size_t WS_PV = 2 * MiB, WS_PQ = WS_PV + 512 * 1024, WS_PKV = WS_PQ + 256 * 1024;
constexpr size_t WS_KPE = 3 * MiB;
constexpr size_t WS_WGU1 = 6 * MiB, WS_WD1 = WS_WGU1 + 44 * MiB, WS_WGU2 = WS_WD1 + 22 * MiB, WS_WD2 = WS_WGU2 + 44 * MiB;
constexpr size_t WS_WIN = WS_WD2 + 22 * MiB, WS_WOUT = WS_WIN + 12 * MiB, WS_WUQ = WS_WOUT + 8 * MiB, WS_WUKV = WS_WUQ + 2 * MiB;
constexpr size_t WS_NB = 162 * MiB;
constexpr size_t WS_MRG = WS_NB + 32 * MiB;
constexpr size_t WS_H = WS_MRG + 32 * MiB;
constexpr size_t WS_HMID = WS_H + 64 * MiB;
constexpr size_t WS_U = WS_HMID, WS_VG = WS_U + 16 * MiB, WS_QL = WS_VG + 16 * MiB, WS_KVL = WS_QL + 8 * MiB;
constexpr size_t WS_QRAW = WS_KVL + 4 * MiB, WS_KVRAW = WS_QRAW + 48 * MiB;
constexpr size_t WS_Q = WS_KVRAW + 64 * MiB, WS_K = WS_Q + 24 * MiB, WS_V = WS_K + 24 * MiB, WS_END = WS_V + 16 * MiB;
static_assert(WS_WUKV + 1 * MiB <= WS_NB && WS_HMID + 88 * MiB <= WS_END, "d_ws map");
constexpr int CW_BAR = 4096;

constexpr int RING_OFF = 0, RING_BYTES = 131072;
constexpr int LDSCTL_OFF = RING_BYTES, MISC_OFF = LDSCTL_OFF + 320, TAB_OFF = RING_BYTES + 1024;
constexpr int LDS_BYTES = 147456;

#define GAS __attribute__((address_space(1)))
#define LAS __attribute__((address_space(3)))
typedef unsigned short bf16;
typedef unsigned v4u __attribute__((ext_vector_type(4)));
typedef unsigned v2u __attribute__((ext_vector_type(2)));
typedef float f32x4 __attribute__((ext_vector_type(4)));
typedef float f32x2 __attribute__((ext_vector_type(2)));
typedef short bf16x8 __attribute__((ext_vector_type(8)));
typedef GAS unsigned gu32;
#define RLX_AGENT __ATOMIC_RELAXED, __HIP_MEMORY_SCOPE_AGENT
#define LDS_WAIT() asm volatile("s_waitcnt lgkmcnt(0)" ::: "memory")
#define VM_WAIT() asm volatile("s_waitcnt vmcnt(0)" ::: "memory")
__device__ __forceinline__ unsigned f2bf(float f) { unsigned u = __builtin_bit_cast(unsigned, f); return (u + 0x7fffu + ((u >> 16) & 1u)) >> 16; }
__device__ __forceinline__ unsigned pk2(float lo, float hi) { return f2bf(lo) | (f2bf(hi) << 16); }
__device__ __forceinline__ float bf2f(unsigned short h) { return __builtin_bit_cast(float, (unsigned)h << 16); }
__device__ __forceinline__ float bflo(unsigned w) { return __builtin_bit_cast(float, w << 16); }
__device__ __forceinline__ float bfhi(unsigned w) { return __builtin_bit_cast(float, w & 0xffff0000u); }

#define XB_TMO      128
#define XB_XCNT(j)  (256  + 64 * (j))
#define XB_XSUB(j)  (1280 + 64 * (j))
#define XB_XGEN(j)  (2304 + 64 * (j))
#define XB_TOP      3328
#define XB_TOPGEN   3392
#define XCD_BAR_WORDS 3456
#define XB_SPIN_CAP (1u << 18)

__device__ __forceinline__ unsigned xb_ld(unsigned* p)              { return __hip_atomic_load(p, __ATOMIC_RELAXED, __HIP_MEMORY_SCOPE_AGENT); }
__device__ __forceinline__ unsigned xb_add(unsigned* p, unsigned v) { return __hip_atomic_fetch_add(p, v, __ATOMIC_RELAXED, __HIP_MEMORY_SCOPE_AGENT); }
__device__ __forceinline__ unsigned xb_xcc_id() { return (unsigned)__builtin_amdgcn_s_getreg((3 << 11) | 20) & 0xFu; }
#define XB_SPIN(cond, bar) do { unsigned _sp = 0; while (cond) { __builtin_amdgcn_s_sleep(1); \
    if ((++_sp & 255u) == 0u) { if (xb_ld(&(bar)[XB_TMO])) break; if (_sp > XB_SPIN_CAP) { atomicAdd(&(bar)[XB_TMO], 1u); break; } } } } while (0)

struct XcdBarrier {
    unsigned* bar; unsigned x;
    volatile LAS unsigned* st;
};

__device__ __forceinline__ XcdBarrier xcd_barrier_post(unsigned* bar, volatile LAS unsigned* st) {
    XcdBarrier b; b.bar = bar; b.x = xb_xcc_id(); b.st = st;
    if (threadIdx.x == 0) (void)xb_add(&bar[XB_XCNT(b.x)], 1u);
    return b;
}
__device__ __forceinline__ void xcd_barrier_complete(unsigned* bar, unsigned x, unsigned& nloc, unsigned& nx) {
    const unsigned G = gridDim.x * gridDim.y * gridDim.z;
    unsigned sum, cnt, mine, sp = 0u;
    for (;;) {
        sum = 0u; cnt = 0u; mine = 0u;
#pragma unroll
        for (unsigned j = 0; j < 16; ++j) { const unsigned c = xb_ld(&bar[XB_XCNT(j)]); sum += c; cnt += (c > 0u) ? 1u : 0u; mine = (j == x) ? c : mine; }
        if (sum == G) break;
        __builtin_amdgcn_s_sleep(1);
        if ((++sp & 255u) == 0u) { if (xb_ld(&bar[XB_TMO])) break; if (sp > XB_SPIN_CAP) { atomicAdd(&bar[XB_TMO], 1u); break; } }
    }
    nloc = mine > 0u ? mine : 1u; nx = cnt > 0u ? cnt : 1u;
}

__device__ __forceinline__ void xcd_barrier(const XcdBarrier& b) {
    asm volatile("s_waitcnt vmcnt(0)" ::: "memory");
    __syncthreads();
    if (threadIdx.x == 0) {
        unsigned* bar = b.bar;
        __builtin_amdgcn_s_waitcnt(0);
        unsigned nloc = b.st[0], nx = b.st[1];
        if (nloc == 0u) { xcd_barrier_complete(bar, b.x, nloc, nx); b.st[0] = nloc; b.st[1] = nx; }
        const unsigned old = xb_add(&bar[XB_XSUB(b.x)], 1u);
        const unsigned gen = old / nloc;
        if (old + 1u == (gen + 1u) * nloc) {
            __builtin_amdgcn_fence(__ATOMIC_RELEASE, "agent");
            asm volatile("s_waitcnt vmcnt(0)" ::: "memory");
            const unsigned og = xb_add(&bar[XB_TOP], 1u);
            const unsigned tg = og / nx;
            if (og + 1u == (tg + 1u) * nx) xb_add(&bar[XB_TOPGEN], 1u);
            else XB_SPIN(xb_ld(&bar[XB_TOPGEN]) == tg, bar);
            __builtin_amdgcn_fence(__ATOMIC_ACQUIRE, "agent");
            xb_add(&bar[XB_XGEN(b.x)], 1u);
            asm volatile("s_waitcnt vmcnt(0)" ::: "memory");
        } else {
            XB_SPIN(xb_ld(&bar[XB_XGEN(b.x)]) == gen, bar);
            __builtin_amdgcn_fence(__ATOMIC_ACQUIRE, "agent");
            asm volatile("s_waitcnt vmcnt(0)" ::: "memory");
        }
    }
    __syncthreads();
}

struct Frame {
    LAS unsigned char* lds;
    volatile LAS unsigned* MISC;
    gu32* ctl;
    int tid, lane, wave;
    int vcu, G;
};
__device__ __forceinline__ float wave_sum(float v) {
#pragma unroll
    for (int o = 1; o < 64; o <<= 1) v += __shfl_xor(v, o);
    return v;
}

__device__ __forceinline__ void p0_mod_gemv(Frame& F, const float* c, const float* w_ada, const float* b_ada, float* mod) {
    LAS float* sc = (LAS float*)(F.lds + RING_OFF);
    LAS float* red = (LAS float*)(F.lds + RING_OFF + 16384);
    for (int i = F.tid; i < 2 * DM; i += NWAVES * 64) { const float v = c[i]; sc[i] = v / (1.0f + __expf(-v)); }
    __syncthreads();
    for (int it = F.vcu; it < MODN / 64; it += F.G) {
        const int j0 = it * 64 + (F.lane & 15) * 4, kr = F.lane >> 4, kbase = F.wave * 256;
        f32x4 a0 = {0.f, 0.f, 0.f, 0.f}, a1 = {0.f, 0.f, 0.f, 0.f};
        const float* wp = w_ada + (size_t)(kbase + kr) * MODN + j0;
#pragma unroll 16
        for (int i = 0; i < 64; ++i) { const int k = kbase + kr + 4 * i; const f32x4 w = *(const f32x4*)(wp + (size_t)(4 * i) * MODN);
            const float s0 = sc[k], s1 = sc[DM + k]; a0 += w * s0; a1 += w * s1; }
#pragma unroll
        for (int e = 0; e < 4; ++e) { a0[e] += __shfl_xor(a0[e], 16); a0[e] += __shfl_xor(a0[e], 32); a1[e] += __shfl_xor(a1[e], 16); a1[e] += __shfl_xor(a1[e], 32); }
        if (F.lane < 16) { *(LAS f32x4*)(red + (F.wave * 2 + 0) * 64 + F.lane * 4) = a0; *(LAS f32x4*)(red + (F.wave * 2 + 1) * 64 + F.lane * 4) = a1; }
        __syncthreads();
        if (F.tid < 128) { const int b = F.tid >> 6, j = F.tid & 63; float s = b_ada[it * 64 + j];
#pragma unroll
            for (int w = 0; w < 8; ++w) s += red[(w * 2 + b) * 64 + j];
            mod[(size_t)b * MODN + it * 64 + j] = s; }
        __syncthreads();
    }
}
template <int MAP> __device__ __forceinline__ int wrow(int n) { return MAP == 0 ? n : (256 * (n >> 7) + (n & 127) + (MAP == 2 ? 128 : 0)); }
template <int MAP> __device__ __forceinline__ void p0_transpose_item(const float* W, int K, int N, bf16* WT, const float* ks0, const float* ks1, int ksplit, LAS float* scr, int item, int lane) {
    const int nblk = N / 32, kb = item / nblk, nb = item % nblk, k0 = 64 * kb, n0 = 32 * nb;
#pragma unroll 8
    for (int i = 0; i < 32; ++i) { const int kk = 2 * i + (lane >> 5); float v = W[(size_t)(k0 + kk) * N + n0 + (lane & 31)];
        if (ks0) { const int k = k0 + kk; v *= (k < ksplit) ? ks0[k] : ks1[k - ksplit]; }
        scr[kk * 33 + (lane & 31)] = v; }
    LDS_WAIT(); asm volatile("" ::: "memory");
    const int c = lane & 7;
#pragma unroll
    for (int j = 0; j < 4; ++j) { const int n = (lane >> 3) + 8 * j; const LAS float* s = scr + (8 * c) * 33 + n;
        v4u o; o.x = pk2(s[0 * 33], s[1 * 33]); o.y = pk2(s[2 * 33], s[3 * 33]); o.z = pk2(s[4 * 33], s[5 * 33]); o.w = pk2(s[6 * 33], s[7 * 33]);
        *(GAS v4u*)(WT + (size_t)wrow<MAP>(n0 + n) * K + k0 + 8 * c) = o; }
    LDS_WAIT(); asm volatile("" ::: "memory");
}
struct Ptrs {
    const float *x, *c; const int* pos; const float *w_ada, *b_ada, *ffn1_norm, *ffn1_wg, *ffn1_wu, *ffn1_wd, *mix_norm, *w_in, *gmlp_v_norm, *gmlp_w_s, *gmlp_b_s,
        *q_lat_norm, *w_uq, *kv_lat_norm, *w_ukv, *q_nope_norm, *q_rope_norm, *k_nope_norm, *k_rope_norm, *out_norm_gmlp, *out_norm_mla, *w_out, *ffn2_norm,
        *ffn2_wg, *ffn2_wu, *ffn2_wd, *final_norm;
    float* out; unsigned char* ws;
};
__device__ __forceinline__ void p0_convert(Frame& F, const Ptrs& P) {
    LAS float* scr = (LAS float*)(F.lds + RING_OFF + F.wave * 16384);
    const int gw = F.vcu * NWAVES + F.wave, NGW = F.G * NWAVES;
    unsigned char* ws = P.ws;
    constexpr int I_GU = (DM / 64) * (DFF / 32), I_D = (DFF / 64) * (DM / 32), I_IN = (DM / 64) * (INCOLS / 32), I_UQ = (QRANK / 64) * (NQ / 32), I_UKV = (KVRANK / 64) * (NKV / 32), I_OUT = (DM / 64) * (DM / 32);
    constexpr int NITEMS = 4 * I_GU + 2 * I_D + I_IN + I_UQ + I_UKV + I_OUT;
    for (int it = gw; it < NITEMS; it += NGW) {
        int r = it;
        if (r < I_GU) { p0_transpose_item<1>(P.ffn1_wg, DM, DFF, (bf16*)(ws + WS_WGU1), nullptr, nullptr, 0, scr, r, F.lane); continue; } r -= I_GU;
        if (r < I_GU) { p0_transpose_item<2>(P.ffn1_wu, DM, DFF, (bf16*)(ws + WS_WGU1), nullptr, nullptr, 0, scr, r, F.lane); continue; } r -= I_GU;
        if (r < I_D)  { p0_transpose_item<0>(P.ffn1_wd, DFF, DM, (bf16*)(ws + WS_WD1), nullptr, nullptr, 0, scr, r, F.lane); continue; } r -= I_D;
        if (r < I_GU) { p0_transpose_item<1>(P.ffn2_wg, DM, DFF, (bf16*)(ws + WS_WGU2), nullptr, nullptr, 0, scr, r, F.lane); continue; } r -= I_GU;
        if (r < I_GU) { p0_transpose_item<2>(P.ffn2_wu, DM, DFF, (bf16*)(ws + WS_WGU2), nullptr, nullptr, 0, scr, r, F.lane); continue; } r -= I_GU;
        if (r < I_D)  { p0_transpose_item<0>(P.ffn2_wd, DFF, DM, (bf16*)(ws + WS_WD2), nullptr, nullptr, 0, scr, r, F.lane); continue; } r -= I_D;
        if (r < I_IN) { p0_transpose_item<0>(P.w_in, DM, INCOLS, (bf16*)(ws + WS_WIN), nullptr, nullptr, 0, scr, r, F.lane); continue; } r -= I_IN;
        if (r < I_UQ) { p0_transpose_item<0>(P.w_uq, QRANK, NQ, (bf16*)(ws + WS_WUQ), P.q_lat_norm, P.q_lat_norm, QRANK, scr, r, F.lane); continue; } r -= I_UQ;
        if (r < I_UKV) { p0_transpose_item<0>(P.w_ukv, KVRANK, NKV, (bf16*)(ws + WS_WUKV), P.kv_lat_norm, P.kv_lat_norm, KVRANK, scr, r, F.lane); continue; } r -= I_UKV;
        p0_transpose_item<0>(P.w_out, DM, DM, (bf16*)(ws + WS_WOUT), P.out_norm_gmlp, P.out_norm_mla, GW, scr, r, F.lane);
    }
    { GAS v4u* z = (GAS v4u*)(ws + WS_WIN + (size_t)INCOLS * DM * 2); const int nz = (INPAD - INCOLS) * DM * 2 / 16;
      for (int i = (F.vcu * NWAVES + F.wave) * 64 + F.lane; i < nz; i += NGW * 64) z[i] = (v4u){0u, 0u, 0u, 0u}; }
}

template <bool FINAL> __device__ __forceinline__ void modnorm_rows(Frame& F, const float* src, const float* nw, const float* sh, const float* sc, bf16* dst, float* dstf) {
    const int gw = F.vcu * NWAVES + F.wave, NGW = F.G * NWAVES;
    for (int m = gw; m < MROWS; m += NGW) {
        const GAS f32x4* xr = (const GAS f32x4*)(src + (size_t)m * DM) + F.lane;
        f32x4 v[8]; float s = 0.f;
#pragma unroll
        for (int j = 0; j < 8; ++j) { v[j] = xr[64 * j]; s += (v[j].x * v[j].x + v[j].y * v[j].y) + (v[j].z * v[j].z + v[j].w * v[j].w); }
        const float rstd = 1.0f / sqrtf(wave_sum(s) * (1.0f / DM) + EPS);
        const int b = m >> 12;
#pragma unroll
        for (int j = 0; j < 8; ++j) { const int cidx = 4 * F.lane + 256 * j; const f32x4 w = *(const f32x4*)(nw + cidx);
            f32x4 y = v[j] * rstd * w;
            if (FINAL) { *(GAS f32x4*)(dstf + (size_t)m * DM + cidx) = y; }
            else { const f32x4 a = *(const f32x4*)(sc + (size_t)b * MODN + cidx), d = *(const f32x4*)(sh + (size_t)b * MODN + cidx);
                y = y * (1.0f + a) + d; v2u o; o.x = pk2(y.x, y.y); o.y = pk2(y.z, y.w); *(GAS v2u*)(dst + (size_t)m * DM + cidx) = o; } }
    }
}

__device__ __forceinline__ void gmlp_phase(Frame& F, const Ptrs& P) {
    const bf16* U = (const bf16*)(P.ws + WS_U); const bf16* VG = (const bf16*)(P.ws + WS_VG); const float* part_v = (const float*)(P.ws + WS_PV);
    bf16* MRG = (bf16*)(P.ws + WS_MRG);
    LAS float* tab = (LAS float*)(F.lds + TAB_OFF);
    const int lane = F.lane, h = F.wave, r32 = lane & 31, hi = lane >> 5;
    char* vbuf = (char*)(F.lds + RING_OFF) + h * 16384;
    const int vb = (int)(uintptr_t)vbuf + att::v_rd_base(lane);
    for (int it = F.vcu; it < 256; it += F.G) {
        const int b = it >> 7, chunk = (it >> 2) & 31, pq = it & 3, R0 = b * SEQ + chunk * 128, p0 = pq * 32;
        if (F.tid < 128) { const float* pp = part_v + (size_t)(R0 + F.tid) * 16; float s = 0.f;
#pragma unroll
            for (int i = 0; i < 4; ++i) { const f32x4 q = *(const f32x4*)(pp + 4 * i); s += (q.x + q.y) + (q.z + q.w); }
            tab[F.tid] = 1.0f / sqrtf(s * (1.0f / GW) + EPS); }
        __syncthreads();
        att::f32x16 o[4] = {};
        const int sc = (lane & 15) * 8;
        const f32x4 vw0 = *(const f32x4*)(P.gmlp_v_norm + h * 128 + sc), vw1 = *(const f32x4*)(P.gmlp_v_norm + h * 128 + sc + 4);
#pragma unroll 1
        for (int t = 0; t < 2; ++t) {
#pragma unroll 4
            for (int i = 0; i < 16; ++i) { const int k = (lane >> 4) + 4 * i, q = 64 * t + k;
                const v4u x = *(const v4u*)(VG + (size_t)(R0 + q) * GW + h * 128 + sc); const float rs = tab[q];
                v4u y; y.x = pk2(bflo(x.x) * rs * vw0.x, bfhi(x.x) * rs * vw0.y); y.y = pk2(bflo(x.y) * rs * vw0.z, bfhi(x.y) * rs * vw0.w);
                y.z = pk2(bflo(x.z) * rs * vw1.x, bfhi(x.z) * rs * vw1.y); y.w = pk2(bflo(x.w) * rs * vw1.z, bfhi(x.w) * rs * vw1.w);
                *(v4u*)(vbuf + att::v_st(k, sc)) = y; }
            bf16x8 pa[4];
#pragma unroll
            for (int ks = 0; ks < 4; ++ks) { const float* wp = P.gmlp_w_s + ((size_t)h * 128 + p0 + r32) * 128 + 64 * t + 16 * ks + 8 * hi;
                const f32x4 a = *(const f32x4*)wp, c = *(const f32x4*)(wp + 4); v4u w; w.x = pk2(a.x, a.y); w.y = pk2(a.z, a.w); w.z = pk2(c.x, c.y); w.w = pk2(c.z, c.w);
                pa[ks] = __builtin_bit_cast(bf16x8, w); }
            LDS_WAIT(); asm volatile("" ::: "memory");
            att::pv_d0(o, vb, pa[0], pa[1], pa[2], pa[3]);
            asm volatile("" ::: "memory");
        }
#pragma unroll
        for (int r = 0; r < 16; ++r) { const int p = p0 + att::crow(r, hi); const size_t row = (size_t)(R0 + p); const float bias = P.gmlp_b_s[h * 128 + p];
#pragma unroll
            for (int d0 = 0; d0 < 4; ++d0) { const int cidx = h * 128 + 32 * d0 + r32; const float uv = bf2f(U[row * GW + cidx]);
                MRG[row * DM + cidx] = (bf16)f2bf(uv * (o[d0][r] + bias)); } }
        __syncthreads();
    }
}

__device__ __forceinline__ void qkv_post(Frame& F, const Ptrs& P) {
    const float* QRAW = (const float*)(P.ws + WS_QRAW); const float* KVRAW = (const float*)(P.ws + WS_KVRAW); const float* KPE = (const float*)(P.ws + WS_KPE);
    bf16* Q = (bf16*)(P.ws + WS_Q); bf16* K = (bf16*)(P.ws + WS_K); bf16* V = (bf16*)(P.ws + WS_V);
    const int gw = F.vcu * NWAVES + F.wave, NGW = F.G * NWAVES, lane = F.lane;
    const float invf = exp2f(-(float)(lane & 31) * (13.287712379549449f / 32.0f));
    const float qnw0 = P.q_nope_norm[2 * lane], qnw1 = P.q_nope_norm[2 * lane + 1], knw0 = P.k_nope_norm[2 * lane], knw1 = P.k_nope_norm[2 * lane + 1];
    const float qrw = P.q_rope_norm[lane], krw = P.k_rope_norm[lane];
    for (int m = gw; m < MROWS; m += NGW) {
        const int b = m >> 12, s = m & (SEQ - 1);
        const float ang = (float)P.pos[m] * invf;
        const double tr = (double)ang * 0.15915494309189535; const float fr = (float)(tr - __builtin_rint(tr));
        const float sn = __builtin_amdgcn_sinf(fr), cs = __builtin_amdgcn_cosf(fr);
        const float* qrow = QRAW + (size_t)m * NQ; const float* kvrow = KVRAW + (size_t)m * NKV;
        float kp = KPE[(size_t)m * ROPE + lane];
        { const float rs = 1.0f / sqrtf(wave_sum(kp * kp) * (1.0f / ROPE) + EPS); kp = kp * rs * krw; const float pr = __shfl_xor(kp, 32); kp = (lane < 32) ? kp * cs - pr * sn : pr * sn + kp * cs; }
        const bf16 kpb = (bf16)f2bf(kp);
#pragma unroll 2
        for (int h = 0; h < NH; ++h) {
            const size_t hrow = ((size_t)(b * NH + h) * SEQ + s);
            const f32x2 qn = *(const f32x2*)(qrow + h * QKD + 2 * lane); float qp = qrow[h * QKD + NOPE + lane];
            const f32x2 kn = *(const f32x2*)(kvrow + h * 256 + 2 * lane); const f32x2 vv = *(const f32x2*)(kvrow + h * 256 + 128 + 2 * lane);
            const float rq = 1.0f / sqrtf(wave_sum(qn.x * qn.x + qn.y * qn.y) * (1.0f / NOPE) + EPS);
            const float rk = 1.0f / sqrtf(wave_sum(kn.x * kn.x + kn.y * kn.y) * (1.0f / NOPE) + EPS);
            const float rp = 1.0f / sqrtf(wave_sum(qp * qp) * (1.0f / ROPE) + EPS);
            qp = qp * rp * qrw; { const float pr = __shfl_xor(qp, 32); qp = (lane < 32) ? qp * cs - pr * sn : pr * sn + qp * cs; }
            *(GAS unsigned*)(Q + hrow * QKD + 2 * lane) = pk2(qn.x * rq * qnw0, qn.y * rq * qnw1);
            Q[hrow * QKD + NOPE + lane] = (bf16)f2bf(qp);
            *(GAS unsigned*)(K + hrow * QKD + 2 * lane) = pk2(kn.x * rk * knw0, kn.y * rk * knw1);
            K[hrow * QKD + NOPE + lane] = kpb;
            *(GAS unsigned*)(V + hrow * VHD + 2 * lane) = pk2(vv.x, vv.y);
        }
    }
}

__device__ __forceinline__ void merged_norm(Frame& F, const Ptrs& P) {
    bf16* MRG = (bf16*)(P.ws + WS_MRG);
    const int gw = F.vcu * NWAVES + F.wave, NGW = F.G * NWAVES;
    for (int m = gw; m < MROWS; m += NGW) {
        GAS v4u* rp = (GAS v4u*)(MRG + (size_t)m * DM) + F.lane;
        v4u x[4]; float ss[4];
#pragma unroll
        for (int j = 0; j < 4; ++j) { x[j] = rp[64 * j]; float s = 0.f;
#pragma unroll
            for (int e = 0; e < 4; ++e) { const float lo = bflo(x[j][e]), hi = bfhi(x[j][e]); s += lo * lo + hi * hi; }
            ss[j] = s; }
        const float ra = 1.0f / sqrtf(wave_sum(ss[0] + ss[1]) * (1.0f / GW) + EPS), rm = 1.0f / sqrtf(wave_sum(ss[2] + ss[3]) * (1.0f / GW) + EPS);
#pragma unroll
        for (int j = 0; j < 4; ++j) { const float r = j < 2 ? ra : rm; v4u y;
#pragma unroll
            for (int e = 0; e < 4; ++e) y[e] = pk2(bflo(x[j][e]) * r, bfhi(x[j][e]) * r);
            rp[64 * j] = y; }
    }
}

struct Args { Ptrs p; int ph_lo, ph_hi; };
__global__ void __launch_bounds__(NWAVES * 64, 2) enc_fwd(Args args) {
    extern __shared__ __attribute__((aligned(16))) unsigned char lds[];
    Frame F;
    F.lds = (LAS unsigned char*)lds;
    F.MISC = (volatile LAS unsigned*)(F.lds + MISC_OFF);
    F.tid = threadIdx.x; F.lane = F.tid & 63; F.wave = __builtin_amdgcn_readfirstlane(F.tid >> 6);
    F.G = gridDim.x; { const int bx = blockIdx.x; F.vcu = (F.G % 8 == 0) ? (bx % 8) * (F.G / 8) + bx / 8 : bx; }
    const Ptrs& P = args.p;
    unsigned char* ws = P.ws;
    F.ctl = (gu32*)(ws + WS_CTL);
    for (int u = F.tid; u < (LDS_BYTES - LDSCTL_OFF) / 4; u += NWAVES * 64) ((LAS unsigned*)(F.lds + LDSCTL_OFF))[u] = 0u;
    __syncthreads();
    XcdBarrier bar; bar.bar = (unsigned*)(F.ctl + CW_BAR); bar.x = 0; bar.st = nullptr;
    if (N_LAUNCHES == 1) bar = xcd_barrier_post((unsigned*)(F.ctl + CW_BAR), F.MISC + 8);
    const int lo = args.ph_lo, hi = args.ph_hi;
#define IN(k) (lo <= (k) && (k) < hi)
#define SEAM(k) do { if (IN(k) && IN((k) + 1)) xcd_barrier(bar); } while (0)
    float* MOD = (float*)(ws + WS_MOD);
    bf16* NB = (bf16*)(ws + WS_NB); bf16* MRG = (bf16*)(ws + WS_MRG); float* H = (float*)(ws + WS_H); bf16* HMID = (bf16*)(ws + WS_HMID);
    const int cid = (int)blockIdx.x;

    if (IN(0)) { p0_mod_gemv(F, P.c, P.w_ada, P.b_ada, MOD); p0_convert(F, P); }
    SEAM(0);
    if (IN(1)) modnorm_rows<false>(F, P.x, P.ffn1_norm, MOD + 0 * DM, MOD + 1 * DM, NB, nullptr);
    SEAM(1);
    if (IN(2)) { pg8::Gemm g{NB, (const bf16*)(ws + WS_WGU1), MROWS, NGU, DM}; pg8::StaticOrder S; S.init(MROWS, NGU, F.G, cid);
        pg8::EpiSwiglu E{HMID, DFF}; pg8::gemm_phase<pg8::EpiSwiglu, pg8::StaticOrder, true, true>(F.lds + RING_OFF, g, S, E); }
    SEAM(2);
    if (IN(3)) { pg8::Gemm g{HMID, (const bf16*)(ws + WS_WD1), MROWS, DM, DFF}; pg8::StaticOrder S; S.init(MROWS, DM, F.G, cid);
        pg8::EpiResid E{P.x, H, DM, MOD + 2 * DM, 0.5f}; pg8::gemm_phase<pg8::EpiResid, pg8::StaticOrder, true, true>(F.lds + RING_OFF, g, S, E); }
    SEAM(3);
    if (IN(4)) modnorm_rows<false>(F, H, P.mix_norm, MOD + 3 * DM, MOD + 4 * DM, NB, nullptr);
    SEAM(4);
    if (IN(5)) { pg8::Gemm g{NB, (const bf16*)(ws + WS_WIN), MROWS, INPAD, DM}; pg8::StaticOrder S; S.init(MROWS, INPAD, F.G, cid);
        pg8::EpiWin E{(bf16*)(ws + WS_U), (bf16*)(ws + WS_VG), (bf16*)(ws + WS_QL), (bf16*)(ws + WS_KVL), (float*)(ws + WS_KPE), (float*)(ws + WS_PV), (float*)(ws + WS_PQ), (float*)(ws + WS_PKV)};
        pg8::gemm_phase<pg8::EpiWin, pg8::StaticOrder, true, true>(F.lds + RING_OFF, g, S, E); }
    SEAM(5);
    if (IN(6)) {
        gmlp_phase(F, P);
        { pg8::Gemm g{(const bf16*)(ws + WS_QL), (const bf16*)(ws + WS_WUQ), MROWS, NQ, QRANK}; pg8::StaticOrder S; S.init(MROWS, NQ, F.G, cid);
          pg8::EpiF32Rs E{(float*)(ws + WS_QRAW), NQ, (const float*)(ws + WS_PQ), 8, 1.0f / QRANK, EPS};
          pg8::gemm_phase<pg8::EpiF32Rs, pg8::StaticOrder, true, true>(F.lds + RING_OFF, g, S, E); }
        { pg8::Gemm g{(const bf16*)(ws + WS_KVL), (const bf16*)(ws + WS_WUKV), MROWS, NKV, KVRANK}; pg8::StaticOrder S; S.init(MROWS, NKV, F.G, cid);
          pg8::EpiF32Rs E{(float*)(ws + WS_KVRAW), NKV, (const float*)(ws + WS_PKV), 4, 1.0f / KVRANK, EPS};
          pg8::gemm_phase<pg8::EpiF32Rs, pg8::StaticOrder, true, true>(F.lds + RING_OFF, g, S, E); }
    }
    SEAM(6);
    if (IN(7)) qkv_post(F, P);
    SEAM(7);
    if (IN(8)) {
        for (int it = F.vcu; it < BATCH * NH * (SEQ / 256); it += F.G) {
            const int bh = it >> 4, qb = it & 15, b = bh >> 3, h = bh & 7;
            const att::bf16* Qb = (const att::bf16*)(ws + WS_Q) + ((size_t)bh * SEQ + qb * 256) * QKD;
            const att::bf16* Kh = (const att::bf16*)(ws + WS_K) + (size_t)bh * SEQ * QKD;
            const att::bf16* Vh = (const att::bf16*)(ws + WS_V) + (size_t)bh * SEQ * VHD;
            att::attn_dense_body(Qb, Kh, Vh, MRG + ((size_t)b * SEQ + qb * 256) * DM + GW + h * VHD, DM, SEQ, (char*)lds + RING_OFF);
            __syncthreads();
        }
    }
    SEAM(8);
    if (IN(9)) merged_norm(F, P);
    SEAM(9);
    if (IN(10)) { pg8::Gemm g{MRG, (const bf16*)(ws + WS_WOUT), MROWS, DM, DM}; pg8::StaticOrder S; S.init(MROWS, DM, F.G, cid);
        pg8::EpiResid E{H, H, DM, MOD + 5 * DM, 1.0f}; pg8::gemm_phase<pg8::EpiResid, pg8::StaticOrder, true, true>(F.lds + RING_OFF, g, S, E); }
    SEAM(10);
    if (IN(11)) modnorm_rows<false>(F, H, P.ffn2_norm, MOD + 6 * DM, MOD + 7 * DM, NB, nullptr);
    SEAM(11);
    if (IN(12)) { pg8::Gemm g{NB, (const bf16*)(ws + WS_WGU2), MROWS, NGU, DM}; pg8::StaticOrder S; S.init(MROWS, NGU, F.G, cid);
        pg8::EpiSwiglu E{HMID, DFF}; pg8::gemm_phase<pg8::EpiSwiglu, pg8::StaticOrder, true, true>(F.lds + RING_OFF, g, S, E); }
    SEAM(12);
    if (IN(13)) { pg8::Gemm g{HMID, (const bf16*)(ws + WS_WD2), MROWS, DM, DFF}; pg8::StaticOrder S; S.init(MROWS, DM, F.G, cid);
        pg8::EpiResid E{H, H, DM, MOD + 8 * DM, 0.5f}; pg8::gemm_phase<pg8::EpiResid, pg8::StaticOrder, true, true>(F.lds + RING_OFF, g, S, E); }
    SEAM(13);
    if (IN(14)) modnorm_rows<true>(F, H, P.final_norm, nullptr, nullptr, nullptr, P.out);
#undef IN
#undef SEAM
}

extern "C" void kernel_launch(void* const* d_in, const int* in_sizes, int n_in, void* d_out, int out_size, void* d_ws, size_t ws_size, hipStream_t stream) {
    static int grid = 0;
    if (grid == 0) {
        if (n_in != 30 || in_sizes[0] != MROWS * DM || out_size != MROWS * DM || ws_size < WS_END) {
            fprintf(stderr, "kernel_launch: shape/workspace mismatch: n_in %d in0 %d out %d ws %zu (need %zu)\n", n_in, n_in > 0 ? in_sizes[0] : -1, out_size, ws_size, (size_t)WS_END); grid = -1; return; }
        int dev = 0, cus = 0, per_cu = 0;
        if (hipGetDevice(&dev) != hipSuccess || hipDeviceGetAttribute(&cus, hipDeviceAttributeMultiprocessorCount, dev) != hipSuccess) { fprintf(stderr, "kernel_launch: device query failed\n"); grid = -1; return; }
        if (hipFuncSetAttribute((const void*)enc_fwd, hipFuncAttributeMaxDynamicSharedMemorySize, LDS_BYTES) != hipSuccess) { fprintf(stderr, "kernel_launch: hipFuncSetAttribute failed\n"); grid = -1; return; }
        if (hipOccupancyMaxActiveBlocksPerMultiprocessor(&per_cu, (const void*)enc_fwd, NWAVES * 64, LDS_BYTES) != hipSuccess || per_cu < 1) {
            fprintf(stderr, "kernel_launch: occupancy query reports %d workgroups per CU; nothing launched\n", per_cu); (void)hipGetLastError(); grid = -1; return; }
        grid = cus;
    }
    if (grid < 0) return;
    if (hipMemsetAsync((char*)d_ws + WS_CTL, 0, CTL_ZERO_BYTES, stream) != hipSuccess) { fprintf(stderr, "kernel_launch: hipMemsetAsync failed\n"); return; }
    Args a{};
    const float** fp = (const float**)&a.p;
    for (int i = 0; i < 30; ++i) fp[i] = (const float*)d_in[i];
    a.p.out = (float*)d_out; a.p.ws = (unsigned char*)d_ws;
    if (N_LAUNCHES == 1) {
        a.ph_lo = 0; a.ph_hi = N_PHASES;
        void* kargs[] = {&a};
        const hipError_t le = hipLaunchCooperativeKernel((const void*)enc_fwd, dim3(grid), dim3(NWAVES * 64), kargs, LDS_BYTES, stream);
        if (le != hipSuccess) fprintf(stderr, "kernel_launch: cooperative launch failed: %s (grid %d)\n", hipGetErrorName(le), grid);
    } else {
        for (int li = 0; li < N_PHASES; ++li) {
            a.ph_lo = li; a.ph_hi = li + 1;
            hipLaunchKernelGGL(enc_fwd, dim3(grid), dim3(NWAVES * 64), LDS_BYTES, stream, a);
            const hipError_t le = hipPeekAtLastError();
            if (le != hipSuccess) { fprintf(stderr, "kernel_launch: launch %d failed: %s\n", li, hipGetErrorName(le)); break; }
        }
    }
}
```
